# Optimizing an MI355X kernel written in HIP

```python
import jax, jax.numpy as jnp
from jax import lax
import numpy as np

D_MODEL = 1024
BATCH = 4
SEQ = 8192
DEPTH = 1

D_MIX = D_MODEL
D_SGU = D_MIX // 2
D_CONV = D_MIX - D_SGU
HEAD_DIM = 64
N_SGU_HEADS = D_SGU // HEAD_DIM
N_CONV_GROUPS = D_CONV // HEAD_DIM
CHUNK = 128
CONV_WIDTH = 31
D_FF = -(-8 * D_MODEL // (3 * 256)) * 256
ALPHA = (2.0 * DEPTH) ** 0.25
BETA = (8.0 * DEPTH) ** -0.25
LN_EPS = 1e-5

kernel_name = "hybrid_sgu_conformer_deepnorm"


def layer_norm(x, g, b):
    xf = x.astype(jnp.float32)
    mu = jnp.mean(xf, axis=-1, keepdims=True)
    var = jnp.mean(jnp.square(xf - mu), axis=-1, keepdims=True)
    y = (xf - mu) * lax.rsqrt(var + LN_EPS)
    return (y * g.astype(jnp.float32) + b.astype(jnp.float32)).astype(x.dtype)


def spatial_gating(z, ln_g, ln_b, w_s, b_s):
    u, v = jnp.split(z, 2, axis=-1)
    v = layer_norm(v, ln_g, ln_b)
    bsz, seq, _ = v.shape
    n_chunks = seq // CHUNK
    v = v.reshape(bsz, n_chunks, CHUNK, N_SGU_HEADS, HEAD_DIM)
    causal = jnp.tril(jnp.ones((CHUNK, CHUNK), dtype=bool))
    w = jnp.where(causal, w_s, 0).astype(v.dtype)
    mixed = jnp.einsum('hts,bcshd->bcthd', w, v) + b_s.T[None, None, :, :, None]
    return u * mixed.reshape(bsz, seq, D_SGU)


def conv_module(a, g, conv_w, conv_b, ln_g, ln_b):
    h = a * jax.nn.sigmoid(g)
    y = lax.conv_general_dilated(
        h, conv_w[:, None, :].astype(h.dtype),
        window_strides=(1,), padding=[(CONV_WIDTH - 1, 0)],
        dimension_numbers=('NWC', 'WIO', 'NWC'),
        feature_group_count=D_CONV) + conv_b
    y = layer_norm(y, ln_g, ln_b)
    return jax.nn.silu(y)


def hybrid_layer(x, w_in, sgu_ln_g, sgu_ln_b, w_s, b_s, conv_w, conv_b, conv_ln_g, conv_ln_b,
                 w_out, ln1_g, ln1_b, w_gate, w_up, w_down, ln2_g, ln2_b):
    proj = jnp.einsum('bsd,de->bse', x, w_in)
    z_sgu = jax.nn.gelu(proj[..., :2 * D_SGU], approximate=False)
    a_conv, g_conv = jnp.split(proj[..., 2 * D_SGU:], 2, axis=-1)
    y = jnp.concatenate([
        spatial_gating(z_sgu, sgu_ln_g, sgu_ln_b, w_s, b_s),
        conv_module(a_conv, g_conv, conv_w, conv_b, conv_ln_g, conv_ln_b),
    ], axis=-1)
    x = layer_norm(ALPHA * x + jnp.einsum('bse,ed->bsd', y, w_out), ln1_g, ln1_b)
    h = jax.nn.silu(jnp.einsum('bsd,df->bsf', x, w_gate)) * jnp.einsum('bsd,df->bsf', x, w_up)
    x = layer_norm(ALPHA * x + jnp.einsum('bsf,fd->bsd', h, w_down), ln2_g, ln2_b)
    return x


def setup_inputs(seed: int = 0) -> dict:
    key = jax.random.key(seed)
    ks = jax.random.split(key, 20)
    f32 = jnp.float32

    def nrm(k, shape, scale):
        return jax.random.normal(k, shape, f32) * scale

    L = DEPTH
    return {
        "x": nrm(ks[0], (BATCH, SEQ, D_MODEL), 1.0),
        "w_in": nrm(ks[1], (L, D_MODEL, 2 * D_SGU + 2 * D_CONV), D_MODEL ** -0.5),
        "sgu_ln_g": 1.0 + nrm(ks[2], (L, D_SGU), 0.02),
        "sgu_ln_b": nrm(ks[3], (L, D_SGU), 0.02),
        "w_s": nrm(ks[4], (L, N_SGU_HEADS, CHUNK, CHUNK), CHUNK ** -0.5),
        "b_s": 1.0 + nrm(ks[5], (L, N_SGU_HEADS, CHUNK), 0.02),
        "conv_w": nrm(ks[6], (L, CONV_WIDTH, D_CONV), CONV_WIDTH ** -0.5),
        "conv_b": nrm(ks[7], (L, D_CONV), 0.02),
        "conv_ln_g": 1.0 + nrm(ks[8], (L, D_CONV), 0.02),
        "conv_ln_b": nrm(ks[9], (L, D_CONV), 0.02),
        "w_out": nrm(ks[10], (L, D_MIX, D_MODEL), BETA * D_MIX ** -0.5),
        "ln1_g": 1.0 + nrm(ks[11], (L, D_MODEL), 0.02),
        "ln1_b": nrm(ks[12], (L, D_MODEL), 0.02),
        "w_gate": nrm(ks[13], (L, D_MODEL, D_FF), D_MODEL ** -0.5),
        "w_up": nrm(ks[14], (L, D_MODEL, D_FF), D_MODEL ** -0.5),
        "w_down": nrm(ks[15], (L, D_FF, D_MODEL), BETA * D_FF ** -0.5),
        "ln2_g": 1.0 + nrm(ks[16], (L, D_MODEL), 0.02),
        "ln2_b": nrm(ks[17], (L, D_MODEL), 0.02),
    }


def reference(x, w_in, sgu_ln_g, sgu_ln_b, w_s, b_s, conv_w, conv_b, conv_ln_g, conv_ln_b,
              w_out, ln1_g, ln1_b, w_gate, w_up, w_down, ln2_g, ln2_b):
    for l in range(DEPTH):
        x = hybrid_layer(x, w_in[l], sgu_ln_g[l], sgu_ln_b[l], w_s[l], b_s[l], conv_w[l], conv_b[l],
                         conv_ln_g[l], conv_ln_b[l], w_out[l], ln1_g[l], ln1_b[l],
                         w_gate[l], w_up[l], w_down[l], ln2_g[l], ln2_b[l])
    return x
```

```cpp
#define FUSED_MASK 0x00
#include <hip/hip_runtime.h>
#include <hip/hip_cooperative_groups.h>
#include <cstdio>
#include <cstdint>
namespace nv {
typedef unsigned short bf16;
__device__ __forceinline__ unsigned short f2bf(float f) { unsigned u = __builtin_bit_cast(unsigned, f); return (unsigned short)((u + 0x7fffu + ((u >> 16) & 1u)) >> 16); }
__device__ __forceinline__ float bf2f(unsigned short b) { return __builtin_bit_cast(float, (unsigned)b << 16); }
__device__ __forceinline__ float gelu_exact(float v) { return 0.5f * v * (1.f + erff(v * 0.70710678118654752f)); }
__device__ __forceinline__ float sigmoidf_(float v) { return 1.f / (1.f + __expf(-v)); }
__device__ __forceinline__ float wave_sum(float v) {
#pragma unroll
    for (int o = 1; o < 64; o <<= 1) v += __shfl_xor(v, o);
    return v;
}
enum { EP_GELU = 0, EP_GLU = 1, EP_RES = 2, EP_SWIGLU = 3 };
template <int EP, bool ABF16>
__global__ void __launch_bounds__(256) ngemm(const void* Av, int lda, const float* B1, const float* B2, int ldb, int K,
                                             void* Out, int ldo, const float* res, float alpha) {
    __shared__ float As[16][68];
    __shared__ float B1s[16][64];
    __shared__ float B2s[16][64];
    const int tid = threadIdx.x, tx = tid & 15, ty = tid >> 4;
    const int m0 = blockIdx.y * 64, n0 = blockIdx.x * 64;
    constexpr bool DUAL = (EP == EP_GLU || EP == EP_SWIGLU);
    float a1[4][4], a2[4][4];
#pragma unroll
    for (int i = 0; i < 4; ++i)
#pragma unroll
        for (int j = 0; j < 4; ++j) { a1[i][j] = 0.f; a2[i][j] = 0.f; }
    for (int k0 = 0; k0 < K; k0 += 16) {
#pragma unroll
        for (int i = 0; i < 4; ++i) {
            const int idx = tid + i * 256; const int m = idx >> 4, k = idx & 15;
            float v;
            if (ABF16) v = bf2f(((const bf16*)Av)[(size_t)(m0 + m) * lda + k0 + k]);
            else v = ((const float*)Av)[(size_t)(m0 + m) * lda + k0 + k];
            As[k][m] = v;
        }
#pragma unroll
        for (int i = 0; i < 4; ++i) {
            const int idx = tid + i * 256; const int k = idx >> 6, n = idx & 63;
            B1s[k][n] = B1[(size_t)(k0 + k) * ldb + n0 + n];
            if (DUAL) B2s[k][n] = B2[(size_t)(k0 + k) * ldb + n0 + n];
        }
        __syncthreads();
#pragma unroll
        for (int k = 0; k < 16; ++k) {
            float av[4], b1v[4], b2v[4];
#pragma unroll
            for (int i = 0; i < 4; ++i) av[i] = As[k][ty * 4 + i];
#pragma unroll
            for (int j = 0; j < 4; ++j) { b1v[j] = B1s[k][tx * 4 + j]; b2v[j] = DUAL ? B2s[k][tx * 4 + j] : 0.f; }
#pragma unroll
            for (int i = 0; i < 4; ++i)
#pragma unroll
                for (int j = 0; j < 4; ++j) { a1[i][j] += av[i] * b1v[j]; if (DUAL) a2[i][j] += av[i] * b2v[j]; }
        }
        __syncthreads();
    }
#pragma unroll
    for (int i = 0; i < 4; ++i)
#pragma unroll
        for (int j = 0; j < 4; ++j) {
            const size_t m = m0 + ty * 4 + i; const int n = n0 + tx * 4 + j;
            if (EP == EP_GELU) ((bf16*)Out)[m * ldo + n] = f2bf(gelu_exact(a1[i][j]));
            if (EP == EP_GLU) ((bf16*)Out)[m * ldo + n] = f2bf(a1[i][j] * sigmoidf_(a2[i][j]));
            if (EP == EP_SWIGLU) ((bf16*)Out)[m * ldo + n] = f2bf(a1[i][j] * sigmoidf_(a1[i][j]) * a2[i][j]);
            if (EP == EP_RES) ((float*)Out)[m * ldo + n] = alpha * res[m * ldo + n] + a1[i][j];
        }
}
template <int N, int MODE>
__global__ void __launch_bounds__(256) nln(const float* in, const float* g, const float* b, float* of, bf16* ob, int ldob, int coloff, int M) {
    const int row = blockIdx.x * 4 + (threadIdx.x >> 6), lane = threadIdx.x & 63;
    if (row >= M) return;
    constexpr int PER = N / 64;
    float v[PER]; float s = 0.f;
#pragma unroll
    for (int j = 0; j < PER; ++j) { v[j] = in[(size_t)row * N + j * 64 + lane]; s += v[j]; }
    const float mean = wave_sum(s) * (1.f / N); float q = 0.f;
#pragma unroll
    for (int j = 0; j < PER; ++j) { v[j] -= mean; q += v[j] * v[j]; }
    const float rstd = 1.f / sqrtf(wave_sum(q) * (1.f / N) + 1e-5f);
#pragma unroll
    for (int j = 0; j < PER; ++j) {
        const int c = j * 64 + lane; float o = v[j] * rstd * g[c] + b[c];
        if (MODE == 0) { of[(size_t)row * N + c] = o; ob[(size_t)row * ldob + coloff + c] = f2bf(o); }
        if (MODE == 1) { o = o * sigmoidf_(o); ob[(size_t)row * ldob + coloff + c] = f2bf(o); }
        if (MODE == 2) of[(size_t)row * N + c] = o;
    }
}
__global__ void __launch_bounds__(256) nvn(const bf16* Z, const float* g, const float* b, float* VN, int M) {
    const int row = blockIdx.x * 4 + (threadIdx.x >> 6), lane = threadIdx.x & 63;
    if (row >= M) return;
    float v[8]; float s = 0.f;
#pragma unroll
    for (int j = 0; j < 8; ++j) { v[j] = bf2f(Z[(size_t)row * 1024 + 512 + j * 64 + lane]); s += v[j]; }
    const float mean = wave_sum(s) * (1.f / 512); float q = 0.f;
#pragma unroll
    for (int j = 0; j < 8; ++j) { v[j] -= mean; q += v[j] * v[j]; }
    const float rstd = 1.f / sqrtf(wave_sum(q) * (1.f / 512) + 1e-5f);
#pragma unroll
    for (int j = 0; j < 8; ++j) { const int c = j * 64 + lane; VN[(size_t)row * 512 + c] = v[j] * rstd * g[c] + b[c]; }
}
__global__ void __launch_bounds__(512) nsgu(const bf16* Z, const float* VN, const float* ws, const float* bs, bf16* Y) {
    const int ck = blockIdx.x, ch = threadIdx.x, h = ch >> 6; const size_t m0 = (size_t)ck * 128;
    for (int t = 0; t < 128; ++t) {
        float acc = 0.f;
        for (int s = 0; s <= t; ++s) acc += ws[(size_t)h * 16384 + t * 128 + s] * VN[(m0 + s) * 512 + ch];
        acc += bs[h * 128 + t];
        const float u = bf2f(Z[(m0 + t) * 1024 + ch]);
        Y[(m0 + t) * 1024 + ch] = f2bf(u * acc);
    }
}
__global__ void __launch_bounds__(256) nconv(const bf16* HC, const float* cw, const float* cb, float* CV, int S) {
    const size_t idx = (size_t)blockIdx.x * 256 + threadIdx.x; const int c = (int)(idx & 511); const size_t m = idx >> 9; const int t = (int)(m % S);
    float acc = cb[c];
    for (int k = 0; k < 31; ++k) { const int tt = t - 30 + k; if (tt >= 0) acc += cw[k * 512 + c] * bf2f(HC[(m - 30 + k) * 512 + c]); }
    CV[idx] = acc;
}
}
namespace cg = cooperative_groups;
constexpr int NWAVES = 8;
constexpr int BATCH = 4, SEQ = 8192, D = 1024, DSGU = 512, DCONV = 512, NH = 8, HD = 64, CHUNK = 128, CW = 31, FF = 2816;
constexpr int M = BATCH * SEQ;
constexpr int NPROJ = 2048, NGU = 2 * FF;
constexpr float LN_EPS = 1e-5f;
constexpr float ALPHA = 1.189207115002721f;
constexpr size_t MiB = 1u << 20;
constexpr size_t WS_CTL = 0, CTL_ZERO_BYTES = 1 * MiB;
constexpr size_t WS_WIN = 2 * MiB, WS_WOUT = 6 * MiB, WS_WGU = 8 * MiB, WS_WD = 20 * MiB, WS_WS = 26 * MiB;
constexpr size_t WS_X1X = 40 * MiB, WS_X2X = 41 * MiB;
constexpr size_t WS_XB = 64 * MiB, WS_Z = 128 * MiB, WS_HC = 192 * MiB, WS_Y = 224 * MiB, WS_X1B = 288 * MiB;
constexpr size_t WS_HB = 64 * MiB;
constexpr size_t WS_VN = 352 * MiB, WS_CV = 416 * MiB, WS_R = 352 * MiB, WS_END = 480 * MiB;
static_assert(WS_HB + (size_t)M * FF * 2 <= WS_X1B, "h overlay must stay clear of X1B");
constexpr int CW_TMO = 0, CW_CODE = 1, CW_SEAM = 16384, SEAM_BANK = 128 * 64;
constexpr int RING_BYTES = 131072;
constexpr int VNT_ROWB = 264;
constexpr int YT_OFF = 0, HT_OFF = 131072, HT_ROWS = CHUNK + CW - 1, HT_BYTES = HT_ROWS * 128;
constexpr int LDS_BYTES = 152576;
static_assert(512 * VNT_ROWB <= LDS_BYTES && HT_OFF + HT_BYTES <= LDS_BYTES, "LDS map");

#define GAS __attribute__((address_space(1)))
#define LAS __attribute__((address_space(3)))
typedef unsigned short bf16;
typedef unsigned v4u __attribute__((ext_vector_type(4)));
typedef unsigned v2u __attribute__((ext_vector_type(2)));
typedef float f32x4 __attribute__((ext_vector_type(4)));
typedef short bf16x8 __attribute__((ext_vector_type(8)));
typedef short bf16x4 __attribute__((ext_vector_type(4)));
#define RLX_AGENT __ATOMIC_RELAXED, __HIP_MEMORY_SCOPE_AGENT
#define LDS_WAIT() asm volatile("s_waitcnt lgkmcnt(0)" ::: "memory")
__device__ __forceinline__ unsigned f2bf(float f) { unsigned u = __builtin_bit_cast(unsigned, f); return (u + 0x7fffu + ((u >> 16) & 1u)) >> 16; }
__device__ __forceinline__ unsigned pk2(float lo, float hi) { return f2bf(lo) | (f2bf(hi) << 16); }
__device__ __forceinline__ float bflo(unsigned w) { return __builtin_bit_cast(float, w << 16); }
__device__ __forceinline__ float bfhi(unsigned w) { return __builtin_bit_cast(float, w & 0xffff0000u); }
__device__ __forceinline__ float wave_sum(float v) {
#pragma unroll
    for (int o = 1; o < 64; o <<= 1) v += __shfl_xor(v, o);
    return v;
}
#if FUSED_MASK != 0
__device__ __forceinline__ void p0_transpose_item(const float* W, int K, int N, bf16* WT, int row_off, LAS float* scr, int kb, int nb, int lane) {
    const int k0 = 64 * kb, n0 = 32 * nb;
#pragma unroll 8
    for (int i = 0; i < 32; ++i) { const int kk = 2 * i + (lane >> 5); scr[kk * 33 + (lane & 31)] = W[(size_t)(k0 + kk) * N + n0 + (lane & 31)]; }
    LDS_WAIT(); asm volatile("" ::: "memory");
    const int c = lane & 7;
#pragma unroll
    for (int j = 0; j < 4; ++j) { const int n = (lane >> 3) + 8 * j; const LAS float* s = scr + (8 * c) * 33 + n;
        v4u o; o.x = pk2(s[0 * 33], s[1 * 33]); o.y = pk2(s[2 * 33], s[3 * 33]); o.z = pk2(s[4 * 33], s[5 * 33]); o.w = pk2(s[6 * 33], s[7 * 33]);
        *(GAS v4u*)(WT + (size_t)(row_off + n0 + n) * K + k0 + 8 * c) = o; }
    LDS_WAIT(); asm volatile("" ::: "memory");
}
#endif
struct Args { const float* in[18]; float* out; unsigned char* ws; int ph_lo, ph_hi; };
enum { I_X = 0, I_WIN, I_SG, I_SB, I_WS, I_BS, I_CW, I_CB, I_CG, I_CBETA, I_WOUT, I_G1, I_B1, I_WG, I_WU, I_WD, I_G2, I_B2 };

#if FUSED_MASK != 0
__device__ __forceinline__ void p0_prologue(const Args& a, LAS unsigned char* lds, int gw, int NGW, int wave, int lane) {
    LAS float* scr = (LAS float*)(lds + wave * 16384);
    unsigned char* ws = a.ws;
    bf16* Win_t = (bf16*)(ws + WS_WIN); bf16* Wout_t = (bf16*)(ws + WS_WOUT); bf16* Wgu_t = (bf16*)(ws + WS_WGU); bf16* Wd_t = (bf16*)(ws + WS_WD);
    constexpr int I_IN = (D / 64) * (NPROJ / 32), I_OUT = (D / 64) * (D / 32), I_G = (D / 64) * (FF / 32), I_DN = (FF / 64) * (D / 32);
    constexpr int NITEMS = I_IN + I_OUT + 2 * I_G + I_DN;
    for (int it = gw; it < NITEMS; it += NGW) {
        int r = it;
        if (r < I_IN) { const int nblk = NPROJ / 32, kb = r / nblk, nb = r % nblk; const int n0 = nb * 32; int dst = n0;
            if (n0 >= 1024) { const int c = n0 - 1024; dst = (c < 512) ? 1024 + (c >> 7) * 256 + (c & 127) : 1024 + ((c - 512) >> 7) * 256 + 128 + ((c - 512) & 127); }
            p0_transpose_item(a.in[I_WIN], D, NPROJ, Win_t, dst - n0, scr, kb, nb, lane); continue; } r -= I_IN;
        if (r < I_OUT) { const int nblk = D / 32; p0_transpose_item(a.in[I_WOUT], D, D, Wout_t, 0, scr, r / nblk, r % nblk, lane); continue; } r -= I_OUT;
        if (r < I_G) { const int nblk = FF / 32, kb = r / nblk, nb = r % nblk, n0 = nb * 32; const int dst = (n0 >> 7) * 256 + (n0 & 127);
            p0_transpose_item(a.in[I_WG], D, FF, Wgu_t, dst - n0, scr, kb, nb, lane); continue; } r -= I_G;
        if (r < I_G) { const int nblk = FF / 32, kb = r / nblk, nb = r % nblk, n0 = nb * 32; const int dst = (n0 >> 7) * 256 + 128 + (n0 & 127);
            p0_transpose_item(a.in[I_WU], D, FF, Wgu_t, dst - n0, scr, kb, nb, lane); continue; } r -= I_G;
        { const int nblk = D / 32; p0_transpose_item(a.in[I_WD], FF, D, Wd_t, 0, scr, r / nblk, r % nblk, lane); }
    }
    { bf16* Wsb = (bf16*)(ws + WS_WS); const float* w = a.in[I_WS];
      for (int i = gw * 64 + lane; i < NH * CHUNK * CHUNK; i += NGW * 64) { const int s = i & 127, t = (i >> 7) & 127; Wsb[i] = (bf16)(s <= t ? f2bf(w[i]) : 0u); } }
    { const float* x = a.in[I_X]; bf16* XB = (bf16*)(ws + WS_XB);
      for (int m = gw; m < M; m += NGW) { const GAS f32x4* xr = (const GAS f32x4*)(x + (size_t)m * D) + lane; GAS v2u* o8 = (GAS v2u*)(XB + (size_t)m * D) + lane;
#pragma unroll
          for (int j = 0; j < 4; ++j) { const f32x4 v = xr[64 * j]; v2u o; o.x = pk2(v.x, v.y); o.y = pk2(v.z, v.w); o8[64 * j] = o; } } }
}

__device__ __forceinline__ void mix_phase(const Args& a, LAS unsigned char* lds, int ck, int tid, int wave, int lane) {
    unsigned char* ws = a.ws;
    const bf16* Z = (const bf16*)(ws + WS_Z); const bf16* HC = (const bf16*)(ws + WS_HC); bf16* Y = (bf16*)(ws + WS_Y); const bf16* Wsb = (const bf16*)(ws + WS_WS);
    const size_t m0 = (size_t)ck * CHUNK;
    {
        float gg[8], bb[8];
#pragma unroll
        for (int j = 0; j < 8; ++j) { gg[j] = a.in[I_SG][j * 64 + lane]; bb[j] = a.in[I_SB][j * 64 + lane]; }
#pragma unroll 4
        for (int i = 0; i < 16; ++i) {
            const int s = wave * 16 + i; const bf16* zr = Z + (m0 + s) * 1024 + 512;
            float v[8]; float sum = 0.f;
#pragma unroll
            for (int j = 0; j < 8; ++j) { v[j] = __builtin_bit_cast(float, (unsigned)zr[j * 64 + lane] << 16); sum += v[j]; }
            const float mean = wave_sum(sum) * (1.f / 512); float q = 0.f;
#pragma unroll
            for (int j = 0; j < 8; ++j) { v[j] -= mean; q += v[j] * v[j]; }
            const float rstd = 1.f / sqrtf(wave_sum(q) * (1.f / 512) + LN_EPS);
#pragma unroll
            for (int j = 0; j < 8; ++j) { const float o = v[j] * rstd * gg[j] + bb[j]; *(LAS unsigned short*)(lds + (j * 64 + lane) * VNT_ROWB + s * 2) = (unsigned short)f2bf(o); }
        }
    }
    __syncthreads();
    {
        const int h = wave, fr = lane & 15, fq = lane >> 4;
        f32x4 acc[8][4];
#pragma unroll
        for (int tb = 0; tb < 8; ++tb)
#pragma unroll
            for (int nb = 0; nb < 4; ++nb) acc[tb][nb] = (f32x4){0.f, 0.f, 0.f, 0.f};
        const bf16* Wh = Wsb + (size_t)h * CHUNK * CHUNK;
#pragma unroll
        for (int kb = 0; kb < 4; ++kb) {
            bf16x8 vf[4];
#pragma unroll
            for (int nb = 0; nb < 4; ++nb) { const LAS unsigned char* p = lds + (h * 64 + nb * 16 + fr) * VNT_ROWB + (kb * 32 + fq * 8) * 2;
                const bf16x4 lo = *(const LAS bf16x4*)p, hi = *(const LAS bf16x4*)(p + 8); vf[nb] = __builtin_shufflevector(lo, hi, 0, 1, 2, 3, 4, 5, 6, 7); }
#pragma unroll
            for (int tb = 0; tb < 8; ++tb) {
                if (kb * 32 <= tb * 16 + 15) {
                    const bf16x8 wf = *(const bf16x8*)(Wh + (tb * 16 + fr) * CHUNK + kb * 32 + fq * 8);
#pragma unroll
                    for (int nb = 0; nb < 4; ++nb) acc[tb][nb] = __builtin_amdgcn_mfma_f32_16x16x32_bf16(vf[nb], wf, acc[tb][nb], 0, 0, 0);
                }
            }
        }
        const float* bs = a.in[I_BS] + h * CHUNK;
#pragma unroll
        for (int tb = 0; tb < 8; ++tb) { const int t = tb * 16 + fr; const float bsv = bs[t];
#pragma unroll
            for (int nb = 0; nb < 4; ++nb) { const size_t off = (m0 + t) * 1024 + h * 64 + nb * 16 + 4 * fq;
                const v2u uu = *(const v2u*)(Z + off); const f32x4 mx = acc[tb][nb] + bsv;
                v2u o; o.x = pk2(bflo(uu.x) * mx[0], bfhi(uu.x) * mx[1]); o.y = pk2(bflo(uu.y) * mx[2], bfhi(uu.y) * mx[3]);
                *(v2u*)(Y + off) = o; } }
    }
    __syncthreads();
    {
        const bool first = ((ck & (SEQ / CHUNK - 1)) == 0);
        for (int g = 0; g < 8; ++g) {
            for (int p = tid; p < HT_ROWS * 8; p += NWAVES * 64) { const int r = p >> 3, c8 = p & 7;
                v4u val = (v4u){0u, 0u, 0u, 0u};
                if (!(first && r < CW - 1)) val = *(const v4u*)(HC + (size_t)((long)m0 - (CW - 1) + r) * 512 + g * 64 + c8 * 8);
                *(LAS v4u*)(lds + HT_OFF + r * 128 + c8 * 16) = val; }
            __syncthreads();
            const int ch = g * 64 + lane;
            float hv[46];
#pragma unroll
            for (int i = 0; i < 46; ++i) hv[i] = __builtin_bit_cast(float, (unsigned)(*(const LAS unsigned short*)(lds + HT_OFF + (wave * 16 + i) * 128 + lane * 2)) << 16);
            float ac[16]; const float bias = a.in[I_CB][ch];
#pragma unroll
            for (int i = 0; i < 16; ++i) ac[i] = bias;
#pragma unroll
            for (int k = 0; k < CW; ++k) { const float w = a.in[I_CW][k * 512 + ch];
#pragma unroll
                for (int i = 0; i < 16; ++i) ac[i] += w * hv[i + k]; }
#pragma unroll
            for (int i = 0; i < 16; ++i) *(LAS unsigned short*)(lds + YT_OFF + (wave * 16 + i) * 1024 + ch * 2) = (unsigned short)f2bf(ac[i]);
            __syncthreads();
        }
    }
    {
        const f32x4 g0 = *(const f32x4*)(a.in[I_CG] + lane * 8), g1 = *(const f32x4*)(a.in[I_CG] + lane * 8 + 4);
        const f32x4 b0 = *(const f32x4*)(a.in[I_CBETA] + lane * 8), b1 = *(const f32x4*)(a.in[I_CBETA] + lane * 8 + 4);
#pragma unroll 2
        for (int i = 0; i < 16; ++i) { const int t = wave * 16 + i;
            const v4u raw = *(const LAS v4u*)(lds + YT_OFF + t * 1024 + lane * 16);
            f32x4 v0 = (f32x4){bflo(raw.x), bfhi(raw.x), bflo(raw.y), bfhi(raw.y)}, v1 = (f32x4){bflo(raw.z), bfhi(raw.z), bflo(raw.w), bfhi(raw.w)};
            const float mean = wave_sum((v0[0] + v0[1]) + (v0[2] + v0[3]) + (v1[0] + v1[1]) + (v1[2] + v1[3])) * (1.f / 512);
            v0 = v0 - mean; v1 = v1 - mean;
            const float q = wave_sum((v0[0] * v0[0] + v0[1] * v0[1]) + (v0[2] * v0[2] + v0[3] * v0[3]) + (v1[0] * v1[0] + v1[1] * v1[1]) + (v1[2] * v1[2] + v1[3] * v1[3]));
            const float rstd = 1.f / sqrtf(q * (1.f / 512) + LN_EPS);
            v0 = v0 * rstd * g0 + b0; v1 = v1 * rstd * g1 + b1;
#pragma unroll
            for (int e = 0; e < 4; ++e) { v0[e] = v0[e] * pg8::sigmoid_fast(v0[e]); v1[e] = v1[e] * pg8::sigmoid_fast(v1[e]); }
            v4u o; o.x = pk2(v0[0], v0[1]); o.y = pk2(v0[2], v0[3]); o.z = pk2(v1[0], v1[1]); o.w = pk2(v1[2], v1[3]);
            *(v4u*)(Y + (m0 + t) * 1024 + 512 + lane * 8) = o; }
    }
    __syncthreads();
}

__global__ void __launch_bounds__(NWAVES * 64, 2) mk_fwd(Args args) {
    extern __shared__ __attribute__((aligned(16))) unsigned char lds_raw[];
    cg::grid_group grid = cg::this_grid();
    LAS unsigned char* lds = (LAS unsigned char*)lds_raw;
    const int tid = threadIdx.x, lane = tid & 63, wave = __builtin_amdgcn_readfirstlane(tid >> 6);
    const int G = gridDim.x, bx = blockIdx.x;
    const int vcu = (G % 8 == 0) ? (bx % 8) * (G / 8) + bx / 8 : bx;
    unsigned char* ws = args.ws;
    unsigned* ctl = (unsigned*)(ws + WS_CTL);
    const int lo = args.ph_lo, hi = args.ph_hi;
#define IN(k) (lo <= (k) && (k) < hi)
#define BOTH(k) (IN(k) && IN((k) + 1))
    bf16* Win_t = (bf16*)(ws + WS_WIN); bf16* Wout_t = (bf16*)(ws + WS_WOUT); bf16* Wgu_t = (bf16*)(ws + WS_WGU); bf16* Wd_t = (bf16*)(ws + WS_WD);
    bf16* XB = (bf16*)(ws + WS_XB); bf16* Z = (bf16*)(ws + WS_Z); bf16* HC = (bf16*)(ws + WS_HC); bf16* Y = (bf16*)(ws + WS_Y); bf16* X1B = (bf16*)(ws + WS_X1B); bf16* HB = (bf16*)(ws + WS_HB);

    if (IN(0)) { p0_prologue(args, lds, vcu * NWAVES + wave, G * NWAVES, wave, lane); if (BOTH(0)) grid.sync(); }

    if (IN(1)) {
        pg8::Gemm g{XB, Win_t, M, NPROJ, D}; pg8::StaticOrder S; S.init(M, NPROJ, G, bx);
        pg8::EpiProj E{Z, HC};
        pg8::gemm_phase<pg8::EpiProj, pg8::StaticOrder, true, true>(lds, g, S, E);
        if (BOTH(1)) grid.sync();
    }
    if (IN(2)) {
        for (int ck = bx; ck < M / CHUNK; ck += G) mix_phase(args, lds, ck, tid, wave, lane);
        if (BOTH(2)) grid.sync();
    }
    if (IN(3)) {
        const unsigned poison = (__hip_atomic_load(ctl + CW_TMO, RLX_AGENT) != 0u) || (G != 256);
        pg8::Gemm g{Y, Wout_t, M, D, D};
        pg8::PanelStats st{(unsigned*)(ws + WS_X1X), ctl + CW_SEAM, ctl + CW_TMO, D / 256, LN_EPS, 0x740u};
        pg8::EpiResLn E{args.in[I_X], args.out, X1B, args.in[I_G1], args.in[I_B1], ALPHA, D, st, poison};
        for (int r = 0; r < 2; ++r) { pg8::RoundOrder S; S.so.init(M, D, G, bx); S.r = r;
            pg8::gemm_phase<pg8::EpiResLn, pg8::RoundOrder, false, true>(lds, g, S, E); __syncthreads(); }
        if (BOTH(3)) grid.sync();
    }
    if (IN(4)) {
        pg8::Gemm g{X1B, Wgu_t, M, NGU, D}; pg8::StaticOrder S; S.init(M, NGU, G, bx);
        pg8::EpiSwiglu E{HB, FF};
        pg8::gemm_phase<pg8::EpiSwiglu, pg8::StaticOrder, true, true>(lds, g, S, E);
        if (BOTH(4)) grid.sync();
    }
    if (IN(5)) {
        const unsigned poison = (__hip_atomic_load(ctl + CW_TMO, RLX_AGENT) != 0u) || (G != 256);
        pg8::Gemm g{HB, Wd_t, M, D, FF};
        pg8::PanelStats st{(unsigned*)(ws + WS_X2X), ctl + CW_SEAM + SEAM_BANK, ctl + CW_TMO, D / 256, LN_EPS, 0x700u};
        pg8::EpiResLn E{args.out, args.out, nullptr, args.in[I_G2], args.in[I_B2], ALPHA, D, st, poison};
        for (int r = 0; r < 2; ++r) { pg8::RoundOrder S; S.so.init(M, D, G, bx); S.r = r;
            pg8::gemm_phase<pg8::EpiResLn, pg8::RoundOrder, false, true>(lds, g, S, E); __syncthreads(); }
    }
#undef IN
#undef BOTH
}
#endif
#ifndef FUSED_MASK
#define FUSED_MASK 0x3e
#endif
static void launch_mk(const Args& a0, int lo, int hi, int grid, hipStream_t stream) {
#if FUSED_MASK != 0
    Args a = a0; a.ph_lo = lo; a.ph_hi = hi;
    void* kargs[] = {(void*)&a};
    hipError_t e = hipLaunchCooperativeKernel((const void*)mk_fwd, dim3(grid), dim3(NWAVES * 64), kargs, LDS_BYTES, stream);
    if (e != hipSuccess) fprintf(stderr, "kernel_launch: cooperative launch [%d,%d) failed: %s (grid %d)\n", lo, hi, hipGetErrorString(e), grid);
#endif
}
extern "C" void kernel_launch(void* const* d_in, const int* in_sizes, int n_in, void* d_out, int out_size, void* d_ws, size_t ws_size, hipStream_t stream) {
    static int grid = 0;
    if (grid == 0) {
        if (n_in != 18 || in_sizes[0] != M * D || out_size != M * D || ws_size < WS_END) { fprintf(stderr, "kernel_launch: shape/workspace mismatch: n_in %d in0 %d out %d ws %zu (need %zu)\n", n_in, n_in > 0 ? in_sizes[0] : -1, out_size, ws_size, (size_t)WS_END); grid = -1; return; }
        int dev = 0, cus = 0, per_cu = 0;
        hipGetDevice(&dev); hipDeviceGetAttribute(&cus, hipDeviceAttributeMultiprocessorCount, dev);
#if FUSED_MASK != 0
        if (hipFuncSetAttribute((const void*)mk_fwd, hipFuncAttributeMaxDynamicSharedMemorySize, LDS_BYTES) != hipSuccess) fprintf(stderr, "kernel_launch: hipFuncSetAttribute failed\n");
        if (hipOccupancyMaxActiveBlocksPerMultiprocessor(&per_cu, (const void*)mk_fwd, NWAVES * 64, LDS_BYTES) != hipSuccess || per_cu < 1) { fprintf(stderr, "kernel_launch: occupancy query says %d\n", per_cu); per_cu = 1; }
#else
        per_cu = 1;
#endif
        (void)hipGetLastError();
        grid = cus * per_cu; if (grid > 256) grid = 256;
        if (grid != 256) fprintf(stderr, "kernel_launch: grid %d (cus %d per_cu %d): fused LayerNorm phases need 256\n", grid, cus, per_cu);
    }
    if (grid < 0) return;
    hipMemsetAsync((char*)d_ws + WS_CTL, 0, CTL_ZERO_BYTES, stream);
    Args a{};
    for (int i = 0; i < 18; ++i) a.in[i] = (const float*)d_in[i];
    a.out = (float*)d_out; a.ws = (unsigned char*)d_ws;
    constexpr int mask = FUSED_MASK;
    if (mask == 0x3e) { launch_mk(a, 0, 6, grid, stream); return; }
#ifndef NO_NAIVE
    unsigned char* ws = (unsigned char*)d_ws;
    nv::bf16 *Z = (nv::bf16*)(ws + WS_Z), *HC = (nv::bf16*)(ws + WS_HC), *Y = (nv::bf16*)(ws + WS_Y), *X1B = (nv::bf16*)(ws + WS_X1B), *HB = (nv::bf16*)(ws + WS_HB);
    float *VN = (float*)(ws + WS_VN), *CV = (float*)(ws + WS_CV), *R = (float*)(ws + WS_R);
    const float* const* in = a.in;
    if (mask != 0) launch_mk(a, 0, 1, grid, stream);
    for (int st = 1; st <= 5; ++st) {
        if (mask & (1 << st)) { launch_mk(a, st, st + 1, grid, stream); continue; }
        if (st == 1) {
            nv::ngemm<nv::EP_GELU, false><<<dim3(1024 / 64, M / 64), 256, 0, stream>>>(in[I_X], D, in[I_WIN], nullptr, NPROJ, D, Z, 1024, nullptr, 0.f);
            nv::ngemm<nv::EP_GLU, false><<<dim3(512 / 64, M / 64), 256, 0, stream>>>(in[I_X], D, in[I_WIN] + 1024, in[I_WIN] + 1536, NPROJ, D, HC, 512, nullptr, 0.f);
        } else if (st == 2) {
            nv::nvn<<<M / 4, 256, 0, stream>>>(Z, in[I_SG], in[I_SB], VN, M);
            nv::nsgu<<<M / CHUNK, 512, 0, stream>>>(Z, VN, in[I_WS], in[I_BS], Y);
            nv::nconv<<<(M * 512) / 256, 256, 0, stream>>>(HC, in[I_CW], in[I_CB], CV, SEQ);
            nv::nln<512, 1><<<M / 4, 256, 0, stream>>>(CV, in[I_CG], in[I_CBETA], nullptr, Y, 1024, 512, M);
        } else if (st == 3) {
            nv::ngemm<nv::EP_RES, true><<<dim3(D / 64, M / 64), 256, 0, stream>>>(Y, D, in[I_WOUT], nullptr, D, D, R, D, in[I_X], ALPHA);
            nv::nln<1024, 0><<<M / 4, 256, 0, stream>>>(R, in[I_G1], in[I_B1], (float*)d_out, X1B, 1024, 0, M);
        } else if (st == 4) {
            nv::ngemm<nv::EP_SWIGLU, true><<<dim3(FF / 64, M / 64), 256, 0, stream>>>(X1B, D, in[I_WG], in[I_WU], FF, D, HB, FF, nullptr, 0.f);
        } else {
            nv::ngemm<nv::EP_RES, true><<<dim3(D / 64, M / 64), 256, 0, stream>>>(HB, FF, in[I_WD], nullptr, D, FF, R, D, (const float*)d_out, ALPHA);
            nv::nln<1024, 2><<<M / 4, 256, 0, stream>>>(R, in[I_G2], in[I_B2], (float*)d_out, nullptr, 0, 0, M);
        }
    }
#endif
}
```
